# Optimizing an MI355X kernel written in HIP

```python
import jax, jax.numpy as jnp
from jax import lax
import numpy as np

D_MODEL = 1024
BATCH = 8
SEQ = 2048
DEPTH = 2

HEAD_DIM = 64
ROPE_THETA = 10000.0
Q_BLOCK = 128
A_HEADS = 8
A_KV_HEADS = 2
A_WINDOW = 128
B_HEADS = 4
IDX_HEADS = 4
IDX_DIM = 64
IDX_TOPK_MAX = 256
IDX_W_SCALE = (IDX_HEADS * IDX_DIM) ** -0.5
C_HEADS = 4
C_NOPE = 64
C_ROPE = 32
C_V = 64
C_Q_RANK = 256
C_KV_RANK = 128
A_Q = A_HEADS * HEAD_DIM
A_KV = A_KV_HEADS * HEAD_DIM
B_Q = B_HEADS * HEAD_DIM
B_KV = HEAD_DIM
IDX_Q = IDX_HEADS * IDX_DIM
IN_SPLITS = (A_Q, A_KV, A_KV, B_Q, B_KV, B_KV, IDX_Q, IDX_DIM, IDX_HEADS, C_Q_RANK, C_KV_RANK, C_ROPE)
IN_COLS = A_Q + 2 * A_KV + B_Q + 2 * B_KV + IDX_Q + IDX_DIM + IDX_HEADS + C_Q_RANK + C_KV_RANK + C_ROPE
MIX_WIDTH = A_HEADS * HEAD_DIM + B_HEADS * HEAD_DIM + C_HEADS * C_V
N_EXPERTS = 16
N_GROUPS = 4
EXPERTS_PER_GROUP = N_EXPERTS // N_GROUPS
TOP_K = 2
D_EXPERT = 256
DEEPNORM_ALPHA = (2 * DEPTH) ** 0.25
DEEPNORM_BETA = (8 * DEPTH) ** -0.25
LN_EPS = 1e-5
RMS_EPS = 1e-6

kernel_name = 'hybrid_swa_dsa_mla_grouped_moe_deepnorm'


def rope_tables(pos, dim):
    inv = 1.0 / (ROPE_THETA ** (jnp.arange(0, dim, 2, dtype=jnp.float32) / dim))
    ang = pos.astype(jnp.float32)[:, None] * inv[None, :]
    return jnp.cos(ang), jnp.sin(ang)


def apply_rope(x, cos, sin):
    d2 = x.shape[-1] // 2
    shape = (1, cos.shape[0]) + (1,) * (x.ndim - 3) + (d2,)
    c = cos.reshape(shape)
    s = sin.reshape(shape)
    xf = x.astype(jnp.float32)
    x1, x2 = xf[..., :d2], xf[..., d2:]
    return jnp.concatenate([x1 * c - x2 * s, x2 * c + x1 * s], axis=-1).astype(x.dtype)


def layer_norm(x, g, b):
    xf = x.astype(jnp.float32)
    mu = jnp.mean(xf, axis=-1, keepdims=True)
    var = jnp.mean(jnp.square(xf - mu), axis=-1, keepdims=True)
    return ((xf - mu) * lax.rsqrt(var + LN_EPS) * g.astype(jnp.float32) + b.astype(jnp.float32)).astype(x.dtype)


def rms_norm(x, g):
    xf = x.astype(jnp.float32)
    return (xf * lax.rsqrt(jnp.mean(jnp.square(xf), axis=-1, keepdims=True) + RMS_EPS) * g.astype(jnp.float32)).astype(x.dtype)


def split_cols(h):
    offs = np.cumsum(IN_SPLITS)[:-1].tolist()
    return jnp.split(h, offs, axis=-1)


def to_blocks(t):
    b, s = t.shape[0], t.shape[1]
    return jnp.moveaxis(t.reshape((b, s // Q_BLOCK, Q_BLOCK) + t.shape[2:]), 1, 0)


def sliding_window_sink_attn(q, k, v, sinks):
    B, S, Hq, D = q.shape
    Hkv = k.shape[2]
    G = Hq // Hkv
    W = A_WINDOW
    nb = S // W
    qb = q.reshape(B, nb, W, Hkv, G, D)

    def band(t):
        tb = t.reshape(B, nb, W, Hkv, D)
        prev = jnp.pad(tb[:, :-1], ((0, 0), (1, 0), (0, 0), (0, 0), (0, 0)))
        return jnp.concatenate([prev, tb], axis=2)

    kb, vb = band(k), band(v)
    s = jnp.einsum('bnqhgd,bnkhd->bnhgqk', qb, kb).astype(jnp.float32) * (D ** -0.5)
    qi = jnp.arange(W)[:, None]
    kj = jnp.arange(2 * W)[None, :]
    diff = qi + W - kj
    in_window = (diff >= 0) & (diff < W)
    not_pad = (jnp.arange(nb)[:, None, None] > 0) | (kj[None] >= W)
    mask = (in_window[None] & not_pad)[None, :, None, None]
    s = jnp.where(mask, s, -jnp.inf)
    sink = jnp.broadcast_to(sinks.astype(jnp.float32).reshape(1, 1, Hkv, G, 1, 1), s.shape[:-1] + (1,))
    p = jax.nn.softmax(jnp.concatenate([s, sink], axis=-1), axis=-1)[..., :-1]
    o = jnp.einsum('bnhgqk,bnkhd->bnqhgd', p.astype(v.dtype), vb)
    return o.reshape(B, S, Hq * D)


def indexer_sparse_attn(q, k, v, q_idx, k_idx, w_idx):
    B, S, H, D = q.shape
    topk = min(IDX_TOPK_MAX, S // 4)
    nb = S // Q_BLOCK
    key_pos = jnp.arange(S)
    bidx = jnp.arange(B)[:, None]

    def block_fn(args):
        qb, qib, wb, t0 = args
        tpos = t0 + jnp.arange(Q_BLOCK)
        logits = jnp.einsum('bthd,bsd->bths', qib, k_idx).astype(jnp.float32)
        score = jnp.einsum('bth,bths->bts', wb.astype(jnp.float32), jax.nn.relu(logits))
        causal = key_pos[None, :] <= tpos[:, None]
        score = jnp.where(causal[None], score, -jnp.inf)
        _, idx = lax.top_k(score, topk)
        flat = idx.reshape(B, Q_BLOCK * topk)
        kg = k[bidx, flat].reshape(B, Q_BLOCK, topk, D)
        vg = v[bidx, flat].reshape(B, Q_BLOCK, topk, D)
        valid = idx <= tpos[None, :, None]
        s = jnp.einsum('bthd,btkd->bthk', qb, kg).astype(jnp.float32) * (D ** -0.5)
        s = jnp.where(valid[:, :, None, :], s, -jnp.inf)
        p = jax.nn.softmax(s, axis=-1)
        return jnp.einsum('bthk,btkd->bthd', p.astype(vg.dtype), vg)

    t0s = jnp.arange(nb, dtype=jnp.int32) * Q_BLOCK
    out = lax.map(block_fn, (to_blocks(q), to_blocks(q_idx), to_blocks(w_idx), t0s))
    return jnp.moveaxis(out, 0, 1).reshape(B, S, H * D)


def mla_attn(q_nope, q_rope, k_nope, k_rope, v):
    B, S, H, Dv = v.shape
    scale = (q_nope.shape[-1] + q_rope.shape[-1]) ** -0.5
    nb = S // Q_BLOCK
    key_pos = jnp.arange(S)

    def block_fn(args):
        qn, qr, t0 = args
        tpos = t0 + jnp.arange(Q_BLOCK)
        s = (jnp.einsum('bthd,bshd->bhts', qn, k_nope) + jnp.einsum('bthd,bsd->bhts', qr, k_rope)).astype(jnp.float32) * scale
        causal = key_pos[None, :] <= tpos[:, None]
        s = jnp.where(causal[None, None], s, -jnp.inf)
        p = jax.nn.softmax(s, axis=-1)
        return jnp.einsum('bhts,bshd->bthd', p.astype(v.dtype), v)

    t0s = jnp.arange(nb, dtype=jnp.int32) * Q_BLOCK
    out = lax.map(block_fn, (to_blocks(q_nope), to_blocks(q_rope), t0s))
    return jnp.moveaxis(out, 0, 1).reshape(B, S, H * Dv)


def moe_ffn(x, w_router, router_bias, w_gate, w_up, w_down):
    B, S, D = x.shape
    N = B * S
    xt = x.reshape(N, D)
    scores = jax.nn.sigmoid(jnp.dot(xt, w_router).astype(jnp.float32))
    biased = (scores + router_bias.astype(jnp.float32)).reshape(N, N_GROUPS, EXPERTS_PER_GROUP)
    group_score = jnp.sum(lax.top_k(biased, TOP_K)[0], axis=-1)
    g_sel = jnp.argmax(group_score, axis=-1)
    in_group = jnp.take_along_axis(biased, g_sel[:, None, None], axis=1)[:, 0]
    _, local = lax.top_k(in_group, TOP_K)
    expert_idx = g_sel[:, None] * EXPERTS_PER_GROUP + local
    w = jnp.take_along_axis(scores, expert_idx, axis=1)
    w = w / jnp.sum(w, axis=-1, keepdims=True)
    gates = jnp.sum(jax.nn.one_hot(expert_idx, N_EXPERTS, dtype=jnp.float32) * w[..., None], axis=1)
    h = jax.nn.silu(jnp.einsum('nd,edf->enf', xt, w_gate)) * jnp.einsum('nd,edf->enf', xt, w_up)
    h = h * gates.T.astype(h.dtype)[:, :, None]
    y = jnp.einsum('enf,efd->nd', h, w_down)
    return y.reshape(B, S, D)


def setup_inputs(seed: int = 0) -> dict:
    key = jax.random.key(seed)
    ks = jax.random.split(key, 20)
    f32 = jnp.float32
    nrm = lambda k, shape, scale: jax.random.normal(k, shape, f32) * scale
    return {
        'x': nrm(ks[0], (BATCH, SEQ, D_MODEL), 1.0),
        'w_in': nrm(ks[1], (DEPTH, D_MODEL, IN_COLS), D_MODEL ** -0.5),
        'attn_sinks': nrm(ks[2], (DEPTH, A_HEADS), 0.5),
        'c_q_norm_g': 1.0 + nrm(ks[3], (DEPTH, C_Q_RANK), 0.02),
        'c_kv_norm_g': 1.0 + nrm(ks[4], (DEPTH, C_KV_RANK), 0.02),
        'w_uq': nrm(ks[5], (DEPTH, C_Q_RANK, C_HEADS * (C_NOPE + C_ROPE)), C_Q_RANK ** -0.5),
        'w_ukv': nrm(ks[6], (DEPTH, C_KV_RANK, C_HEADS * (C_NOPE + C_V)), C_KV_RANK ** -0.5),
        'w_out': nrm(ks[7], (DEPTH, MIX_WIDTH, D_MODEL), DEEPNORM_BETA * MIX_WIDTH ** -0.5),
        'ln1_g': 1.0 + nrm(ks[8], (DEPTH, D_MODEL), 0.02),
        'ln1_b': nrm(ks[9], (DEPTH, D_MODEL), 0.02),
        'w_router': nrm(ks[10], (D_MODEL, N_EXPERTS), D_MODEL ** -0.5),
        'router_bias': nrm(ks[11], (N_EXPERTS,), 0.01),
        'w_gate': nrm(ks[12], (DEPTH, N_EXPERTS, D_MODEL, D_EXPERT), D_MODEL ** -0.5),
        'w_up': nrm(ks[13], (DEPTH, N_EXPERTS, D_MODEL, D_EXPERT), D_MODEL ** -0.5),
        'w_down': nrm(ks[14], (DEPTH, N_EXPERTS, D_EXPERT, D_MODEL), DEEPNORM_BETA * D_EXPERT ** -0.5),
        'ln2_g': 1.0 + nrm(ks[15], (DEPTH, D_MODEL), 0.02),
        'ln2_b': nrm(ks[16], (DEPTH, D_MODEL), 0.02),
    }


def reference(x, w_in, attn_sinks, c_q_norm_g, c_kv_norm_g, w_uq, w_ukv, w_out, ln1_g, ln1_b, w_router, router_bias, w_gate, w_up, w_down, ln2_g, ln2_b):
    B, S, _ = x.shape
    pos = jnp.arange(S)
    cos_h, sin_h = rope_tables(pos, HEAD_DIM)
    cos_r, sin_r = rope_tables(pos, C_ROPE)
    for l in range(DEPTH):
        h = jnp.einsum('bsd,dc->bsc', x, w_in[l])
        a_q, a_k, a_v, b_q, b_k, b_v, i_q, i_k, i_w, c_q, c_kv, c_kr = split_cols(h)
        o_a = sliding_window_sink_attn(
            apply_rope(a_q.reshape(B, S, A_HEADS, HEAD_DIM), cos_h, sin_h),
            apply_rope(a_k.reshape(B, S, A_KV_HEADS, HEAD_DIM), cos_h, sin_h),
            a_v.reshape(B, S, A_KV_HEADS, HEAD_DIM), attn_sinks[l])
        o_b = indexer_sparse_attn(
            apply_rope(b_q.reshape(B, S, B_HEADS, HEAD_DIM), cos_h, sin_h),
            apply_rope(b_k, cos_h, sin_h), b_v,
            apply_rope(i_q.reshape(B, S, IDX_HEADS, IDX_DIM), cos_h, sin_h),
            apply_rope(i_k, cos_h, sin_h), i_w * IDX_W_SCALE)
        q_c = jnp.einsum('bsr,rc->bsc', rms_norm(c_q, c_q_norm_g[l]), w_uq[l]).reshape(B, S, C_HEADS, C_NOPE + C_ROPE)
        kv_c = jnp.einsum('bsr,rc->bsc', rms_norm(c_kv, c_kv_norm_g[l]), w_ukv[l]).reshape(B, S, C_HEADS, C_NOPE + C_V)
        o_c = mla_attn(q_c[..., :C_NOPE], apply_rope(q_c[..., C_NOPE:], cos_r, sin_r),
                       kv_c[..., :C_NOPE], apply_rope(c_kr, cos_r, sin_r), kv_c[..., C_NOPE:])
        mix = jnp.concatenate([o_a, o_b, o_c], axis=-1)
        x = layer_norm(DEEPNORM_ALPHA * x + jnp.einsum('bsm,md->bsd', mix, w_out[l]), ln1_g[l], ln1_b[l])
        x = layer_norm(DEEPNORM_ALPHA * x + moe_ffn(x, w_router, router_bias, w_gate[l], w_up[l], w_down[l]), ln2_g[l], ln2_b[l])
    return x
```

```cpp
#include <hip/hip_runtime.h>
#include <stdint.h>

#define D_MODEL 1024
#define BATCH 8
#define SEQ 2048
#define NTOK (BATCH * SEQ)
#define DEPTH 2
#define IN_COLS 1892
#define MIXW 1024
#define NEXP 16
#define DEXP 256

#define O_AQ 0
#define O_AK 512
#define O_AV 640
#define O_BQ 768
#define O_BK 1024
#define O_BV 1088
#define O_IQ 1152
#define O_IK 1408
#define O_IW 1472
#define O_CQ 1476
#define O_CKV 1732
#define O_CKR 1860

template <int ACC>
__global__ __launch_bounds__(256) void gemm_f32(const float* __restrict__ A, int lda, const float* __restrict__ B, int ldb,
                                                float* C, int ldc, int M, int N, int K) {
    __shared__ float As[16][65];
    __shared__ float Bs[16][65];
    const int tx = threadIdx.x & 15, ty = threadIdx.x >> 4;
    const int m0 = blockIdx.y * 64, n0 = blockIdx.x * 64;
    float acc[4][4];
#pragma unroll
    for (int i = 0; i < 4; ++i)
#pragma unroll
        for (int j = 0; j < 4; ++j) acc[i][j] = 0.f;
    for (int k0 = 0; k0 < K; k0 += 16) {
        for (int i = threadIdx.x; i < 64 * 16; i += 256) {
            int r = i >> 4, c = i & 15;
            As[c][r] = A[(size_t)(m0 + r) * lda + k0 + c];
        }
        for (int i = threadIdx.x; i < 16 * 64; i += 256) {
            int r = i >> 6, c = i & 63;
            Bs[r][c] = (n0 + c < N) ? B[(size_t)(k0 + r) * ldb + n0 + c] : 0.f;
        }
        __syncthreads();
#pragma unroll
        for (int kk = 0; kk < 16; ++kk) {
            float a[4], b[4];
#pragma unroll
            for (int i = 0; i < 4; ++i) a[i] = As[kk][ty * 4 + i];
#pragma unroll
            for (int j = 0; j < 4; ++j) b[j] = Bs[kk][tx * 4 + j];
#pragma unroll
            for (int i = 0; i < 4; ++i)
#pragma unroll
                for (int j = 0; j < 4; ++j) acc[i][j] += a[i] * b[j];
        }
        __syncthreads();
    }
#pragma unroll
    for (int i = 0; i < 4; ++i)
#pragma unroll
        for (int j = 0; j < 4; ++j) {
            int m = m0 + ty * 4 + i, n = n0 + tx * 4 + j;
            if (n < N) {
                if (ACC) C[(size_t)m * ldc + n] += acc[i][j];
                else C[(size_t)m * ldc + n] = acc[i][j];
            }
        }
}

static void gemm(hipStream_t s, const float* A, int lda, const float* B, int ldb, float* C, int ldc, int M, int N, int K, bool acc) {
    dim3 g((N + 63) / 64, M / 64);
    if (acc) gemm_f32<1><<<g, 256, 0, s>>>(A, lda, B, ldb, C, ldc, M, N, K);
    else gemm_f32<0><<<g, 256, 0, s>>>(A, lda, B, ldb, C, ldc, M, N, K);
}

__global__ void rope_k(float* buf, int ld, int col0, int nheads, int hstride, int hoff, int dim) {
    const int d2 = dim / 2;
    const int per_tok = nheads * d2;
    size_t idx = (size_t)blockIdx.x * blockDim.x + threadIdx.x;
    if (idx >= (size_t)NTOK * per_tok) return;
    int tok = (int)(idx / per_tok), r = (int)(idx % per_tok);
    int hd = r / d2, j = r % d2;
    int pos = tok % SEQ;
    float inv = 1.0f / powf(10000.0f, (float)(2 * j) / (float)dim);
    float ang = (float)pos * inv;
    float c = cosf(ang), s = sinf(ang);
    float* p = buf + (size_t)tok * ld + col0 + hd * hstride + hoff;
    float x1 = p[j], x2 = p[j + d2];
    p[j] = x1 * c - x2 * s;
    p[j + d2] = x2 * c + x1 * s;
}
static void rope(hipStream_t s, float* buf, int ld, int col0, int nheads, int hstride, int hoff, int dim) {
    size_t n = (size_t)NTOK * nheads * (dim / 2);
    rope_k<<<(unsigned)((n + 255) / 256), 256, 0, s>>>(buf, ld, col0, nheads, hstride, hoff, dim);
}

__global__ __launch_bounds__(64) void attn_a_k(const float* __restrict__ h, const float* __restrict__ sinks, float* mix) {
    const int tok = blockIdx.x >> 3, hq = blockIdx.x & 7, kvh = hq >> 2;
    const int b = tok / SEQ, t = tok % SEQ, lane = threadIdx.x;
    __shared__ float qs[64];
    __shared__ float ps[128];
    qs[lane] = h[(size_t)tok * IN_COLS + O_AQ + hq * 64 + lane];
    __syncthreads();
    float lg[2];
#pragma unroll
    for (int i = 0; i < 2; ++i) {
        int s = t - lane - 64 * i;
        if (s >= 0) {
            const float* kp = h + (size_t)(b * SEQ + s) * IN_COLS + O_AK + kvh * 64;
            float a = 0.f;
            for (int d = 0; d < 64; ++d) a += qs[d] * kp[d];
            lg[i] = a * 0.125f;
        } else lg[i] = -INFINITY;
    }
    float sink = sinks[hq];
    float m = fmaxf(fmaxf(lg[0], lg[1]), sink);
    for (int o = 32; o >= 1; o >>= 1) m = fmaxf(m, __shfl_xor(m, o));
    float p0 = expf(lg[0] - m), p1 = expf(lg[1] - m);
    float sum = p0 + p1;
    for (int o = 32; o >= 1; o >>= 1) sum += __shfl_xor(sum, o);
    sum += expf(sink - m);
    ps[lane] = p0 / sum;
    ps[lane + 64] = p1 / sum;
    __syncthreads();
    float o = 0.f;
    for (int j = 0; j < 128; ++j) {
        int s = t - j;
        if (s < 0) break;
        o += ps[j] * h[(size_t)(b * SEQ + s) * IN_COLS + O_AV + kvh * 64 + lane];
    }
    mix[(size_t)tok * MIXW + hq * 64 + lane] = o;
}

__device__ __forceinline__ unsigned f2key(float f) {
    if (f == 0.f) f = 0.f;
    unsigned u = __float_as_uint(f);
    return (u & 0x80000000u) ? ~u : (u | 0x80000000u);
}
__global__ __launch_bounds__(256) void attn_b_k(const float* __restrict__ h, float* mix) {
    const int tok = blockIdx.x, b = tok / SEQ, t = tok % SEQ, tid = threadIdx.x;
    __shared__ float qi[256];
    __shared__ float qb[256];
    __shared__ unsigned keys[SEQ];
    __shared__ float lg[SEQ];
    __shared__ float red[256];
    __shared__ unsigned cnt;
    __shared__ int s_idx;
    const float* hr = h + (size_t)tok * IN_COLS;
    qi[tid] = hr[O_IQ + tid];
    qb[tid] = hr[O_BQ + tid];
    float w[4];
#pragma unroll
    for (int i = 0; i < 4; ++i) w[i] = hr[O_IW + i] * 0.0625f;
    __syncthreads();
    const int n = t + 1;
    for (int s = tid; s < SEQ; s += 256) {
        if (s < n) {
            const float* kp = h + (size_t)(b * SEQ + s) * IN_COLS + O_IK;
            float sc = 0.f;
#pragma unroll
            for (int hd = 0; hd < 4; ++hd) {
                float a = 0.f;
                for (int d = 0; d < 64; ++d) a += qi[hd * 64 + d] * kp[d];
                sc += w[hd] * fmaxf(a, 0.f);
            }
            keys[s] = f2key(sc);
        } else keys[s] = 0u;
    }
    __syncthreads();
    unsigned tau = 0u;
    int idx_tau = 0x7fffffff;
    if (n > 256) {
        unsigned long long lo = 0ull, hi = 0x100000000ull;
        while (hi - lo > 1ull) {
            unsigned long long mid = lo + ((hi - lo) >> 1);
            if (tid == 0) cnt = 0u;
            __syncthreads();
            unsigned c = 0;
            for (int s = tid; s < n; s += 256) c += ((unsigned long long)keys[s] >= mid) ? 1u : 0u;
            if (c) atomicAdd(&cnt, c);
            __syncthreads();
            unsigned tot = cnt;
            __syncthreads();
            if (tot >= 256u) lo = mid; else hi = mid;
        }
        tau = (unsigned)lo;
        if (tid == 0) cnt = 0u;
        __syncthreads();
        unsigned c = 0;
        for (int s = tid; s < n; s += 256) c += (keys[s] > tau) ? 1u : 0u;
        if (c) atomicAdd(&cnt, c);
        __syncthreads();
        if (tid == 0) {
            int r = 256 - (int)cnt;
            int found = 0x7fffffff;
            for (int s = 0; s < n; ++s)
                if (keys[s] == tau) { if (--r == 0) { found = s; break; } }
            s_idx = found;
        }
        __syncthreads();
        idx_tau = s_idx;
    }
    const int lane = tid & 63;
    for (int hh = 0; hh < 4; ++hh) {
        __syncthreads();
        for (int s = tid; s < n; s += 256) {
            bool sel = (n <= 256) || (keys[s] > tau) || (keys[s] == tau && s <= idx_tau);
            float v = -INFINITY;
            if (sel) {
                const float* kp = h + (size_t)(b * SEQ + s) * IN_COLS + O_BK;
                float a = 0.f;
                for (int d = 0; d < 64; ++d) a += qb[hh * 64 + d] * kp[d];
                v = a * 0.125f;
            }
            lg[s] = v;
        }
        __syncthreads();
        float mm = -INFINITY;
        for (int s = tid; s < n; s += 256) mm = fmaxf(mm, lg[s]);
        red[tid] = mm;
        __syncthreads();
        for (int o = 128; o >= 1; o >>= 1) { if (tid < o) red[tid] = fmaxf(red[tid], red[tid + o]); __syncthreads(); }
        mm = red[0];
        __syncthreads();
        float sm = 0.f;
        for (int s = tid; s < n; s += 256) { float p = expf(lg[s] - mm); lg[s] = p; sm += p; }
        red[tid] = sm;
        __syncthreads();
        for (int o = 128; o >= 1; o >>= 1) { if (tid < o) red[tid] += red[tid + o]; __syncthreads(); }
        sm = red[0];
        __syncthreads();
        float o = 0.f;
        for (int s = (tid >> 6); s < n; s += 4) {
            float p = lg[s];
            if (p != 0.f) o += p * h[(size_t)(b * SEQ + s) * IN_COLS + O_BV + lane];
        }
        red[tid] = o;
        __syncthreads();
        if (tid < 64) mix[(size_t)tok * MIXW + 512 + hh * 64 + tid] = (red[tid] + red[tid + 64] + red[tid + 128] + red[tid + 192]) / sm;
        __syncthreads();
    }
}

__global__ __launch_bounds__(256) void attn_c_k(const float* __restrict__ h, const float* __restrict__ qc, const float* __restrict__ kvc, float* mix) {
    const int tok = blockIdx.x >> 2, hd = blockIdx.x & 3, b = tok / SEQ, t = tok % SEQ, tid = threadIdx.x;
    __shared__ float q[96];
    __shared__ float lg[SEQ];
    __shared__ float red[256];
    if (tid < 96) q[tid] = qc[(size_t)tok * 384 + hd * 96 + tid];
    __syncthreads();
    const int n = t + 1;
    const float scale = 0.10206207261596575f;
    float mm = -INFINITY;
    for (int s = tid; s < n; s += 256) {
        const float* kn = kvc + (size_t)(b * SEQ + s) * 512 + hd * 128;
        const float* kr = h + (size_t)(b * SEQ + s) * IN_COLS + O_CKR;
        float a = 0.f;
        for (int d = 0; d < 64; ++d) a += q[d] * kn[d];
        for (int d = 0; d < 32; ++d) a += q[64 + d] * kr[d];
        a *= scale;
        lg[s] = a;
        mm = fmaxf(mm, a);
    }
    red[tid] = mm;
    __syncthreads();
    for (int o = 128; o >= 1; o >>= 1) { if (tid < o) red[tid] = fmaxf(red[tid], red[tid + o]); __syncthreads(); }
    mm = red[0];
    __syncthreads();
    float sm = 0.f;
    for (int s = tid; s < n; s += 256) { float p = expf(lg[s] - mm); lg[s] = p; sm += p; }
    red[tid] = sm;
    __syncthreads();
    for (int o = 128; o >= 1; o >>= 1) { if (tid < o) red[tid] += red[tid + o]; __syncthreads(); }
    sm = red[0];
    __syncthreads();
    const int lane = tid & 63;
    float o = 0.f;
    for (int s = (tid >> 6); s < n; s += 4) o += lg[s] * kvc[(size_t)(b * SEQ + s) * 512 + hd * 128 + 64 + lane];
    red[tid] = o;
    __syncthreads();
    if (tid < 64) mix[(size_t)tok * MIXW + 768 + hd * 64 + tid] = (red[tid] + red[tid + 64] + red[tid + 128] + red[tid + 192]) / sm;
}

__global__ __launch_bounds__(256) void ln_res_k(const float* __restrict__ xa, const float* __restrict__ y, const float* __restrict__ g,
                                                const float* __restrict__ bta, float* out) {
    const int tok = blockIdx.x, tid = threadIdx.x;
    __shared__ float red[256];
    const float alpha = 1.4142135623730951f;
    float v[4];
    float s = 0.f;
#pragma unroll
    for (int i = 0; i < 4; ++i) {
        int c = tid + 256 * i;
        v[i] = alpha * xa[(size_t)tok * D_MODEL + c] + y[(size_t)tok * D_MODEL + c];
        s += v[i];
    }
    red[tid] = s;
    __syncthreads();
    for (int o = 128; o >= 1; o >>= 1) { if (tid < o) red[tid] += red[tid + o]; __syncthreads(); }
    float mean = red[0] / (float)D_MODEL;
    __syncthreads();
    float q = 0.f;
#pragma unroll
    for (int i = 0; i < 4; ++i) { float d = v[i] - mean; q += d * d; }
    red[tid] = q;
    __syncthreads();
    for (int o = 128; o >= 1; o >>= 1) { if (tid < o) red[tid] += red[tid + o]; __syncthreads(); }
    float rstd = rsqrtf(red[0] / (float)D_MODEL + 1e-5f);
#pragma unroll
    for (int i = 0; i < 4; ++i) {
        int c = tid + 256 * i;
        out[(size_t)tok * D_MODEL + c] = (v[i] - mean) * rstd * g[c] + bta[c];
    }
}

__global__ __launch_bounds__(64) void router_k(const float* __restrict__ x1, const float* __restrict__ wr, const float* __restrict__ rb, float* gates) {
    const int tok = blockIdx.x, lane = threadIdx.x;
    float acc[16];
#pragma unroll
    for (int e = 0; e < 16; ++e) acc[e] = 0.f;
    for (int k = lane; k < D_MODEL; k += 64) {
        float xv = x1[(size_t)tok * D_MODEL + k];
#pragma unroll
        for (int e = 0; e < 16; ++e) acc[e] += xv * wr[k * 16 + e];
    }
#pragma unroll
    for (int e = 0; e < 16; ++e)
        for (int o = 32; o >= 1; o >>= 1) acc[e] += __shfl_xor(acc[e], o);
    if (lane == 0) {
        float sc[16], bi[16];
#pragma unroll
        for (int e = 0; e < 16; ++e) { sc[e] = 1.f / (1.f + expf(-acc[e])); bi[e] = sc[e] + rb[e]; }
        int gsel = 0; float gbest = -INFINITY;
        for (int g = 0; g < 4; ++g) {
            float a = -INFINITY, b2 = -INFINITY;
            for (int j = 0; j < 4; ++j) { float v = bi[g * 4 + j]; if (v > a) { b2 = a; a = v; } else if (v > b2) b2 = v; }
            float gs = a + b2;
            if (gs > gbest) { gbest = gs; gsel = g; }
        }
        int i1 = 0; float v1 = -INFINITY;
        for (int j = 0; j < 4; ++j) { float v = bi[gsel * 4 + j]; if (v > v1) { v1 = v; i1 = j; } }
        int i2 = -1; float v2 = -INFINITY;
        for (int j = 0; j < 4; ++j) { if (j == i1) continue; float v = bi[gsel * 4 + j]; if (v > v2) { v2 = v; i2 = j; } }
        int e1 = gsel * 4 + i1, e2 = gsel * 4 + i2;
        float w1 = sc[e1], w2 = sc[e2], ws = w1 + w2;
        for (int e = 0; e < 16; ++e) gates[(size_t)tok * 16 + e] = 0.f;
        gates[(size_t)tok * 16 + e1] = w1 / ws;
        gates[(size_t)tok * 16 + e2] = w2 / ws;
    }
}

__global__ void swiglu_k(float* G, const float* __restrict__ U, const float* __restrict__ gates, int e) {
    size_t idx = (size_t)blockIdx.x * blockDim.x + threadIdx.x;
    if (idx >= (size_t)NTOK * DEXP) return;
    int tok = (int)(idx / DEXP);
    float g = G[idx], u = U[idx];
    float gt = gates[(size_t)tok * 16 + e];
    G[idx] = (g / (1.f + expf(-g))) * u * gt;
}

__global__ __launch_bounds__(256) void rms_strided_k(const float* __restrict__ h, int col0, int n, const float* __restrict__ g, float* out, int ldo) {
    const int tok = blockIdx.x, tid = threadIdx.x;
    __shared__ float red[256];
    float v = (tid < n) ? h[(size_t)tok * IN_COLS + col0 + tid] : 0.f;
    red[tid] = v * v;
    __syncthreads();
    for (int o = 128; o >= 1; o >>= 1) { if (tid < o) red[tid] += red[tid + o]; __syncthreads(); }
    float r = rsqrtf(red[0] / (float)n + 1e-6f);
    if (tid < n) out[(size_t)tok * ldo + tid] = v * r * g[tid];
}

extern "C" void kernel_launch(void* const* d_in, const int* in_sizes, int n_in, void* d_out, int out_size, void* d_ws, size_t ws_size,
                              hipStream_t stream) {
    const float* x_in = (const float*)d_in[0];
    const float* w_in = (const float*)d_in[1];
    const float* sinks = (const float*)d_in[2];
    const float* cq_g = (const float*)d_in[3];
    const float* ckv_g = (const float*)d_in[4];
    const float* w_uq = (const float*)d_in[5];
    const float* w_ukv = (const float*)d_in[6];
    const float* w_out = (const float*)d_in[7];
    const float* ln1_g = (const float*)d_in[8];
    const float* ln1_b = (const float*)d_in[9];
    const float* w_router = (const float*)d_in[10];
    const float* router_bias = (const float*)d_in[11];
    const float* w_gate = (const float*)d_in[12];
    const float* w_up = (const float*)d_in[13];
    const float* w_down = (const float*)d_in[14];
    const float* ln2_g = (const float*)d_in[15];
    const float* ln2_b = (const float*)d_in[16];
    float* out = (float*)d_out;

    char* ws = (char*)d_ws;
    float* h = (float*)ws;
    float* mix = (float*)(ws + 123994112);
    float* x1 = (float*)(ws + 123994112 + 67108864);
    float* gates = (float*)(ws + 123994112 + 2 * 67108864);
    float* qc = x1;
    float* kvc = x1 + (size_t)NTOK * 384;
    float* Y = h;
    float* G = h + (size_t)NTOK * 1024;
    float* U = h + (size_t)NTOK * 1280;

    for (int l = 0; l < DEPTH; ++l) {
        const float* xa = (l == 0) ? x_in : out;
        gemm(stream, xa, D_MODEL, w_in + (size_t)l * D_MODEL * IN_COLS, IN_COLS, h, IN_COLS, NTOK, IN_COLS, D_MODEL, false);
        rope(stream, h, IN_COLS, O_AQ, 8, 64, 0, 64);
        rope(stream, h, IN_COLS, O_AK, 2, 64, 0, 64);
        rope(stream, h, IN_COLS, O_BQ, 4, 64, 0, 64);
        rope(stream, h, IN_COLS, O_BK, 1, 64, 0, 64);
        rope(stream, h, IN_COLS, O_IQ, 4, 64, 0, 64);
        rope(stream, h, IN_COLS, O_IK, 1, 64, 0, 64);
        rope(stream, h, IN_COLS, O_CKR, 1, 32, 0, 32);
        attn_a_k<<<NTOK * 8, 64, 0, stream>>>(h, sinks + l * 8, mix);
        attn_b_k<<<NTOK, 256, 0, stream>>>(h, mix);
        rms_strided_k<<<NTOK, 256, 0, stream>>>(h, O_CQ, 256, cq_g + l * 256, mix + 768, MIXW);
        gemm(stream, mix + 768, MIXW, w_uq + (size_t)l * 256 * 384, 384, qc, 384, NTOK, 384, 256, false);
        rms_strided_k<<<NTOK, 256, 0, stream>>>(h, O_CKV, 128, ckv_g + l * 128, mix + 768, MIXW);
        gemm(stream, mix + 768, MIXW, w_ukv + (size_t)l * 128 * 512, 512, kvc, 512, NTOK, 512, 128, false);
        rope(stream, qc, 384, 0, 4, 96, 64, 32);
        attn_c_k<<<NTOK * 4, 256, 0, stream>>>(h, qc, kvc, mix);
        gemm(stream, mix, MIXW, w_out + (size_t)l * MIXW * D_MODEL, D_MODEL, Y, D_MODEL, NTOK, D_MODEL, MIXW, false);
        ln_res_k<<<NTOK, 256, 0, stream>>>(xa, Y, ln1_g + l * D_MODEL, ln1_b + l * D_MODEL, x1);
        router_k<<<NTOK, 64, 0, stream>>>(x1, w_router, router_bias, gates);
        for (int e = 0; e < NEXP; ++e) {
            const float* wg = w_gate + ((size_t)l * NEXP + e) * D_MODEL * DEXP;
            const float* wu = w_up + ((size_t)l * NEXP + e) * D_MODEL * DEXP;
            const float* wd = w_down + ((size_t)l * NEXP + e) * DEXP * D_MODEL;
            gemm(stream, x1, D_MODEL, wg, DEXP, G, DEXP, NTOK, DEXP, D_MODEL, false);
            gemm(stream, x1, D_MODEL, wu, DEXP, U, DEXP, NTOK, DEXP, D_MODEL, false);
            swiglu_k<<<(NTOK * DEXP + 255) / 256, 256, 0, stream>>>(G, U, gates, e);
            gemm(stream, G, DEXP, wd, D_MODEL, Y, D_MODEL, NTOK, D_MODEL, DEXP, e != 0);
        }
        ln_res_k<<<NTOK, 256, 0, stream>>>(x1, Y, ln2_g + l * D_MODEL, ln2_b + l * D_MODEL, out);
    }
}
```
